# Optimizing an MI355X kernel written in HIP

```python
import jax, jax.numpy as jnp
from jax import lax
import numpy as np

D_MODEL = 4096
BATCH = 2
SEQ = 4096
DEPTH = 2

GRID_W = 64
CTX_LEN = 256
D_POOL = D_MODEL // 2
POOL_WINDOWS = (2, 4, 8, 16)
N_POOL_GROUPS = len(POOL_WINDOWS)
D_POOL_GROUP = D_POOL // N_POOL_GROUPS
HEAD_DIM = 128
D_ATTN = D_MODEL // 2
N_HEADS = D_ATTN // HEAD_DIM
NA_KH_MAX = 8
NA_KW = 16
NA_QB_W = 16
NA_NCB = GRID_W // NA_QB_W
NA_CW = 2 * NA_KW
D_IN = 2 * D_POOL + 4 * D_ATTN + 2 * D_MODEL
RMS_EPS = 1e-6
NEG_INF = -1e30

kernel_name = "hybrid_pool_natten_prefix_dit"


def _rmsnorm(x, g):
    xf = x.astype(jnp.float32)
    y = xf * lax.rsqrt(jnp.mean(xf * xf, axis=-1, keepdims=True) + RMS_EPS)
    return (y * g.astype(jnp.float32)).astype(x.dtype)


def _modulate(x, g, shift, scale):
    return _rmsnorm(x, g) * (1 + scale) + shift


def _split_proj(p):
    sizes = (D_POOL, D_POOL, D_ATTN, D_ATTN, D_ATTN, D_ATTN, D_MODEL, D_MODEL)
    return jnp.split(p, [int(i) for i in np.cumsum(sizes)[:-1]], axis=-1)


def _heads(a):
    b, l, _ = a.shape
    return a.reshape(b, l, N_HEADS, HEAD_DIM)


def _pool_mix(u, w_pool, s_pool):
    b, l, _ = u.shape
    uf = u.astype(jnp.float32)
    csum = jnp.concatenate([jnp.zeros((b, 1, D_POOL), jnp.float32), jnp.cumsum(uf, axis=1)], axis=1)
    t = jnp.arange(l)
    outs = []
    for gi, w in enumerate(POOL_WINDOWS):
        lo = jnp.clip(t - w // 2, 0, l - 1)
        hi = jnp.clip(t - w // 2 + w - 1, 0, l - 1)
        cols = slice(gi * D_POOL_GROUP, (gi + 1) * D_POOL_GROUP)
        window_sum = csum[:, hi + 1, cols] - csum[:, lo, cols]
        count = (hi - lo + 1).astype(jnp.float32)[None, :, None]
        outs.append(window_sum / count - uf[:, :, cols])
    p = jnp.stack(outs, axis=2).astype(u.dtype)
    p = jnp.einsum('blgc,gcd->blgd', p, w_pool).reshape(b, l, D_POOL)
    return p * s_pool


def _na_column_tables():
    j = np.arange(NA_NCB)
    col_start = np.clip(j * NA_QB_W - NA_KW // 2, 0, GRID_W - NA_CW)
    key_col = col_start[:, None] + np.arange(NA_CW)[None, :]
    q_col = j[:, None] * NA_QB_W + np.arange(NA_QB_W)[None, :]
    win_start = np.clip(q_col - NA_KW // 2, 0, GRID_W - NA_KW)
    kc = key_col[:, None, :]
    valid = (kc >= win_start[:, :, None]) & (kc < win_start[:, :, None] + NA_KW)
    dc_idx = np.clip(kc - q_col[:, :, None] + NA_KW - 1, 0, 2 * NA_KW - 2)
    return key_col, valid, dc_idx


def _neighbourhood_attention(q, k, v, kc, vc, rpb):
    b, l = q.shape[:2]
    rows = l // GRID_W
    kh = min(NA_KH_MAX, rows)

    def grid(a):
        return a.transpose(0, 2, 1, 3).reshape(b, N_HEADS, rows, GRID_W, HEAD_DIM)

    qg, kg, vg = grid(q * HEAD_DIM ** -0.5), grid(k), grid(v)
    kct, vct = kc.transpose(0, 2, 1, 3), vc.transpose(0, 2, 1, 3)
    key_col, valid, dc_idx = _na_column_tables()
    n_loc = kh * NA_CW

    def row(r):
        rs = jnp.clip(r - kh // 2, 0, rows - kh)
        q_r = lax.dynamic_index_in_dim(qg, r, axis=2, keepdims=False)
        q_r = q_r.reshape(b, N_HEADS, NA_NCB, NA_QB_W, HEAD_DIM)
        k_rows = lax.dynamic_slice_in_dim(kg, rs, kh, axis=2)
        v_rows = lax.dynamic_slice_in_dim(vg, rs, kh, axis=2)
        k_blk = k_rows[:, :, :, key_col]
        v_blk = v_rows[:, :, :, key_col]
        dr_idx = rs + jnp.arange(kh) - r + NA_KH_MAX - 1
        bias = rpb[:, dr_idx[None, None, :, None], dc_idx[:, :, None, :]]
        s_loc = jnp.einsum('bhjqd,bhrjkd->bhjqrk', q_r, k_blk).astype(jnp.float32)
        s_loc = jnp.where(valid[:, :, None, :], s_loc + bias.astype(jnp.float32)[None], NEG_INF)
        s_ctx = jnp.einsum('bhjqd,bhkd->bhjqk', q_r, kct).astype(jnp.float32)
        s = jnp.concatenate([s_loc.reshape(b, N_HEADS, NA_NCB, NA_QB_W, n_loc), s_ctx], axis=-1)
        p = jax.nn.softmax(s, axis=-1).astype(v.dtype)
        p_loc = p[..., :n_loc].reshape(b, N_HEADS, NA_NCB, NA_QB_W, kh, NA_CW)
        p_ctx = p[..., n_loc:]
        o = (jnp.einsum('bhjqrk,bhrjkd->bhjqd', p_loc, v_blk)
             + jnp.einsum('bhjqk,bhkd->bhjqd', p_ctx, vct))
        return o.reshape(b, N_HEADS, GRID_W, HEAD_DIM)

    out = lax.map(row, jnp.arange(rows))
    return out.transpose(1, 0, 3, 2, 4).reshape(b, l, D_ATTN)


def _context_attention(qc, kc, vc):
    b, lc = qc.shape[:2]
    s = jnp.einsum('bqhd,bkhd->bhqk', qc * HEAD_DIM ** -0.5, kc).astype(jnp.float32)
    p = jax.nn.softmax(s, axis=-1).astype(vc.dtype)
    return jnp.einsum('bhqk,bkhd->bqhd', p, vc).reshape(b, lc, D_ATTN)


def _merge(y_pool, z_pool, y_attn, z_attn, g_pool, g_attn, w_br_pool, w_br_attn, w_out):
    br_pool = (y_pool * jax.nn.silu(z_pool)) @ w_br_pool
    br_attn = (y_attn * jax.nn.silu(z_attn)) @ w_br_attn
    return (jax.nn.sigmoid(g_pool) * br_pool + jax.nn.sigmoid(g_attn) * br_attn) @ w_out


def setup_inputs(seed: int = 0) -> dict:
    key = jax.random.key(seed)
    ks = jax.random.split(key, 16)
    f32 = jnp.float32
    d = D_MODEL
    nrm = lambda k, shape, s: jax.random.normal(k, shape, f32) * s
    return {
        "x": nrm(ks[0], (BATCH, SEQ, d), 1.0),
        "c": nrm(ks[1], (BATCH, d), 1.0),
        "ctx": nrm(ks[2], (BATCH, CTX_LEN, d), 1.0),
        "c_ctx": nrm(ks[3], (d,), 1.0),
        "norm_g": 1.0 + nrm(ks[4], (DEPTH, d), 0.05),
        "w_ada": nrm(ks[5], (DEPTH, d, 3 * d), 0.5 * d ** -0.5),
        "b_ada": nrm(ks[6], (DEPTH, 3 * d), 0.02),
        "w_in": nrm(ks[7], (DEPTH, d, D_IN), d ** -0.5),
        "b_in": nrm(ks[8], (DEPTH, D_IN), 0.02),
        "w_pool": nrm(ks[9], (DEPTH, N_POOL_GROUPS, D_POOL_GROUP, D_POOL_GROUP), D_POOL_GROUP ** -0.5),
        "s_pool": 1.0 + nrm(ks[10], (DEPTH, D_POOL), 0.1),
        "rpb": nrm(ks[11], (DEPTH, N_HEADS, 2 * NA_KH_MAX - 1, 2 * NA_KW - 1), 0.1),
        "w_br_pool": nrm(ks[12], (DEPTH, D_POOL, d), D_POOL ** -0.5),
        "w_br_attn": nrm(ks[13], (DEPTH, D_ATTN, d), D_ATTN ** -0.5),
        "w_out": nrm(ks[14], (DEPTH, d, d), d ** -0.5),
        "final_g": 1.0 + nrm(ks[15], (d,), 0.05),
    }


def reference(x, c, ctx, c_ctx, norm_g, w_ada, b_ada, w_in, b_in, w_pool, s_pool, rpb,
              w_br_pool, w_br_attn, w_out, final_g):
    x_lat, x_ctx = x, ctx
    kv_lo = 2 * D_POOL + D_ATTN
    for l in range(DEPTH):
        last = l == DEPTH - 1
        ada_lat = jax.nn.silu(c) @ w_ada[l] + b_ada[l]
        sh, sc, gt = jnp.split(ada_lat[:, None, :], 3, axis=-1)
        ada_ctx = jax.nn.silu(c_ctx) @ w_ada[l] + b_ada[l]
        sh_c, sc_c, gt_c = jnp.split(ada_ctx, 3)
        h_lat = _modulate(x_lat, norm_g[l], sh, sc)
        h_ctx = _modulate(x_ctx, norm_g[l], sh_c, sc_c)

        u_l, zp_l, q_l, k_l, v_l, za_l, gp_l, ga_l = _split_proj(h_lat @ w_in[l] + b_in[l])
        if last:
            kv_c = h_ctx @ w_in[l][:, kv_lo:kv_lo + 2 * D_ATTN] + b_in[l][kv_lo:kv_lo + 2 * D_ATTN]
            k_c, v_c = jnp.split(kv_c, 2, axis=-1)
        else:
            u_c, zp_c, q_c, k_c, v_c, za_c, gp_c, ga_c = _split_proj(h_ctx @ w_in[l] + b_in[l])
        kc, vc = _heads(k_c), _heads(v_c)

        y_pool_l = _pool_mix(u_l, w_pool[l], s_pool[l])
        y_attn_l = _neighbourhood_attention(_heads(q_l), _heads(k_l), _heads(v_l), kc, vc, rpb[l])
        mix_lat = _merge(y_pool_l, zp_l, y_attn_l, za_l, gp_l, ga_l, w_br_pool[l], w_br_attn[l], w_out[l])

        if not last:
            y_pool_c = _pool_mix(u_c, w_pool[l], s_pool[l])
            y_attn_c = _context_attention(_heads(q_c), kc, vc)
            mix_ctx = _merge(y_pool_c, zp_c, y_attn_c, za_c, gp_c, ga_c, w_br_pool[l], w_br_attn[l], w_out[l])
            x_ctx = x_ctx + gt_c * mix_ctx
        x_lat = x_lat + gt * mix_lat
    return _rmsnorm(x_lat, final_g)
```

```cpp
#include <hip/hip_runtime.h>
#include <cstdio>
#include <cstdint>

#ifndef MK_N_LAUNCHES
#define MK_N_LAUNCHES 0
#endif

#define LAS __attribute__((address_space(3)))
#define GAS __attribute__((address_space(1)))
typedef unsigned short bf16_t;
typedef short bf16x8 __attribute__((ext_vector_type(8)));
typedef short s16x4 __attribute__((ext_vector_type(4)));
typedef float f32x2 __attribute__((ext_vector_type(2)));
typedef float f32x4 __attribute__((ext_vector_type(4)));
typedef float f32x16 __attribute__((ext_vector_type(16)));
typedef unsigned u32x2 __attribute__((ext_vector_type(2)));
typedef unsigned u32x4 __attribute__((ext_vector_type(4)));

constexpr int DM = 4096, NB = 2, SEQ = 4096, NL = 2, CTX = 256, GW = 64;
constexpr int MLAT = NB * SEQ, MCTX = NB * CTX, MTOT = MLAT + MCTX;
constexpr int DIN = 20480, DPOOL = 2048, DATT = 2048, NH = 16, HD = 128;
constexpr int C_U = 0, C_ZP = 2048, C_Q = 4096, C_K = 6144, C_V = 8192, C_ZA = 10240, C_GP = 12288, C_GA = 16384;
constexpr int ADA_N = 3 * DM, ADA_KS = 8;
constexpr float RMS_EPS = 1e-6f, LOG2E = 1.4426950408889634f;
constexpr float QSCALE = 0.08838834764831845f * LOG2E;

constexpr size_t MiB = 1u << 20;
constexpr size_t WS_CTL = 0, CTL_ZERO_BYTES = 1 * MiB;
constexpr size_t WS_ADAP = 1 * MiB;
constexpr size_t WS_GT   = 4 * MiB;
constexpr size_t WS_WPOOL = 6 * MiB;
constexpr size_t WS_WIN  = WS_WPOOL + (size_t)NL * 4 * 512 * 512 * 2 + 2 * MiB;
static_assert(WS_ADAP + (size_t)NL * ADA_KS * 3 * ADA_N * 4 <= WS_GT && WS_GT + (size_t)NL * 3 * DM * 4 <= WS_WPOOL, "d_ws map");
constexpr size_t WS_WBR  = WS_WIN + (size_t)NL * DIN * DM * 2;
constexpr size_t WS_WOUT = WS_WBR + (size_t)NL * DM * DM * 2;
constexpr size_t WS_H    = WS_WOUT + (size_t)NL * DM * DM * 2;
constexpr size_t WS_P    = WS_H + (size_t)MTOT * DM * 2;
constexpr size_t WS_PP   = WS_P + (size_t)MTOT * DIN * 2;
constexpr size_t WS_YZ   = WS_PP + (size_t)MTOT * DPOOL * 2;
constexpr size_t WS_MRG  = WS_YZ + (size_t)MTOT * DM * 2;
constexpr size_t WS_XL   = WS_MRG + (size_t)MTOT * DM * 2;
constexpr size_t WS_XC   = WS_XL + (size_t)MLAT * DM * 4;
constexpr size_t WS_END  = WS_XC + (size_t)MCTX * DM * 4;
constexpr int CW_TMO = 0, CW_BAR = 4096;

constexpr int RING_BYTES = 131072;
constexpr int LDS_BYTES = 147456;
constexpr int MISC_OFF = LDS_BYTES - 256;
constexpr int NWAVES = 8;

__device__ __forceinline__ unsigned cvt_pk_bf16(float lo, float hi) { unsigned r; asm volatile("v_cvt_pk_bf16_f32 %0, %1, %2" : "=v"(r) : "v"(lo), "v"(hi)); return r; }
__device__ __forceinline__ float bf_lo(unsigned w) { return __uint_as_float(w << 16); }
__device__ __forceinline__ float bf_hi(unsigned w) { return __uint_as_float(w & 0xffff0000u); }
__device__ __forceinline__ float bf1(bf16_t v) { return __uint_as_float(((unsigned)v) << 16); }
__device__ __forceinline__ float sigmoid_f(float x) { return __builtin_amdgcn_rcpf(1.0f + __builtin_amdgcn_exp2f(-x * LOG2E)); }
__device__ __forceinline__ float silu_f(float x) { return x * sigmoid_f(x); }
__device__ __forceinline__ float wave_sum(float v) {
#pragma unroll
    for (int o = 1; o < 64; o <<= 1) v += __shfl_xor(v, o);
    return v;
}
#define LDS_WAIT() asm volatile("s_waitcnt lgkmcnt(0)" ::: "memory")
#define VM_WAIT() asm volatile("s_waitcnt vmcnt(0)" ::: "memory")

namespace pg8 {
constexpr int BM = 256, BK = 64, HALF = 128, HTB = HALF * BK * 2, STAGE_BYTES = 8 * HTB;
__host__ __device__ __forceinline__ int lds_byte(int r, int c) { const int st = (r >> 4) * 2 + (c >> 5), rr = r & 15, cc = c & 31, ob = rr * 64 + cc * 2; return st * 1024 + (ob ^ (((ob >> 9) & 1) << 5)); }
__host__ __device__ __forceinline__ void stage_rc(int b, int& R, int& C) { const int st = b / 1024, sb = b % 1024, swz = sb ^ (((sb >> 9) & 1) << 5); R = (st >> 1) * 16 + swz / 64; C = (st & 1) * 32 + (swz % 64) / 2; }
__host__ __device__ __forceinline__ int perm32(int rho) { const int n = rho >> 4, i = rho & 15; return 8 * (i >> 2) + 4 * n + (i & 3); }

struct Unit { const char* A; const char* B; int row0, col0; };

template <class Epi, class Sched>
__device__ __forceinline__ void gemm_phase(LAS unsigned char* lds, const int lda, const int ldb, const int K, const Sched& S, const Epi& E) {
    int tid = threadIdx.x; asm volatile("" : "+v"(tid));
    const int wid = __builtin_amdgcn_readfirstlane(tid >> 6), lane = tid & 63, wr = wid >> 2, wc = wid & 3, fr = lane & 15, fq = lane >> 4;
    const int nt = K / BK;
    unsigned voffA[2], voffB[2];
#pragma unroll
    for (int i = 0; i < 2; ++i) { int R, C; stage_rc(tid * 16 + i * 8192, R, C); const int Rb = Epi::PERM ? ((R & ~31) + perm32(R & 31)) : R;
        voffA[i] = (unsigned)(R * lda + C) * 2u; voffB[i] = (unsigned)(Rb * ldb + C) * 2u; }
    const size_t kstep = (size_t)(BK * 2);
    const size_t hstepA = (size_t)HALF * lda * 2, hstepB = (size_t)HALF * ldb * 2;
    const unsigned ldsw = (unsigned)wid * 1024u;
    const int aoff = lds_byte(wr * 64 + fr, fq * 8), boff = lds_byte(wc * 32 + fr, fq * 8);
#define PG8_SA(b, h) (((b) * 2 + (h)) * HTB)
#define PG8_SB(b, h) ((4 + (b) * 2 + (h)) * HTB)
#define PG8_STAGE(bufoff, gbase, voff) do { _Pragma("unroll") for (int _i = 0; _i < 2; ++_i) \
        __builtin_amdgcn_global_load_lds((const GAS unsigned*)((const char*)(gbase) + (voff)[_i]), (LAS unsigned*)(lds + (bufoff) + ldsw + _i * 8192), 16, 0, 0); } while (0)
#define PG8_LDA(dst, b, h) do { _Pragma("unroll") for (int m = 0; m < 4; ++m) _Pragma("unroll") for (int k = 0; k < 2; ++k) dst[m][k] = *(const LAS bf16x8*)(lds + PG8_SA(b, h) + aoff + m * 2048 + k * 1024); } while (0)
#define PG8_LDB(dst, b, h) do { _Pragma("unroll") for (int n = 0; n < 2; ++n) _Pragma("unroll") for (int k = 0; k < 2; ++k) dst[n][k] = *(const LAS bf16x8*)(lds + PG8_SB(b, h) + boff + n * 2048 + k * 1024); } while (0)
#define PG8_MMA(ai, bj, At, Bt) do { __builtin_amdgcn_s_setprio(1); _Pragma("unroll") for (int m = 0; m < 4; ++m) _Pragma("unroll") for (int n = 0; n < 2; ++n) _Pragma("unroll") for (int k = 0; k < 2; ++k) \
        acc[ai][bj][m][n] = __builtin_amdgcn_mfma_f32_16x16x32_bf16(Bt[n][k], At[m][k], acc[ai][bj][m][n], 0, 0, 0); __builtin_amdgcn_s_setprio(0); } while (0)
#define PG8_WAIT_V(n) asm volatile("s_waitcnt vmcnt(" #n ")" ::: "memory")
#define PG8_WAIT_L(n) asm volatile("s_waitcnt lgkmcnt(" #n ")" ::: "memory")
#define PG8_BAR __builtin_amdgcn_s_barrier()
#define PG8_SCHED __builtin_amdgcn_sched_barrier(0)
    Unit cur, nxt; int ui = 0;
    if (!S.next(0, cur)) return;
    f32x4 acc[2][2][4][2];
#pragma unroll
    for (int a = 0; a < 2; ++a)
#pragma unroll
        for (int b = 0; b < 2; ++b)
#pragma unroll
            for (int m = 0; m < 4; ++m)
#pragma unroll
                for (int n = 0; n < 2; ++n) acc[a][b][m][n] = (f32x4){0.f, 0.f, 0.f, 0.f};
    bf16x8 At[4][2], B0[2][2], B1[2][2];
    const char* cA = cur.A; const char* cB = cur.B;
    PG8_STAGE(PG8_SB(0, 0), cB, voffB); PG8_STAGE(PG8_SB(0, 1), cB + hstepB, voffB); PG8_STAGE(PG8_SA(0, 0), cA, voffA); PG8_STAGE(PG8_SA(0, 1), cA + hstepA, voffA);
    if (wr == 1) PG8_BAR;
    PG8_WAIT_V(2); PG8_BAR;
    PG8_STAGE(PG8_SB(1, 0), cB + kstep, voffB); PG8_STAGE(PG8_SA(1, 0), cA + kstep, voffA); PG8_STAGE(PG8_SB(1, 1), cB + hstepB + kstep, voffB);
    PG8_WAIT_V(6); PG8_BAR;
    for (;;) {
        const bool has_next = S.next(ui + 1, nxt);
        const char* nA = has_next ? nxt.A : cA; const char* nB = has_next ? nxt.B : cB;
        for (int t = 0; t < nt; t += 2) {
            const bool last = (t == nt - 2);
            const char* a1 = cA + (size_t)(t + 1) * kstep;
            const char* a2 = last ? nA : cA + (size_t)(t + 2) * kstep; const char* b2 = last ? nB : cB + (size_t)(t + 2) * kstep;
            const char* a3 = a2 + kstep; const char* b3 = b2 + kstep;
            if constexpr (Epi::MIDK) { if (t == (nt >> 1)) E.mid(acc, cur, wr, wc, fr, fq); }
            PG8_LDB(B0, 0, 0); PG8_LDB(B1, 0, 1); PG8_SCHED; PG8_LDA(At, 0, 0); PG8_STAGE(PG8_SA(1, 1), a1 + hstepA, voffA);
            PG8_WAIT_V(8); PG8_WAIT_L(0); PG8_BAR; PG8_MMA(0, 0, At, B0); PG8_MMA(0, 1, At, B1); PG8_BAR; PG8_SCHED;
            PG8_LDA(At, 0, 1); PG8_STAGE(PG8_SB(0, 0), b2, voffB); PG8_STAGE(PG8_SB(0, 1), b2 + hstepB, voffB); PG8_STAGE(PG8_SA(0, 0), a2, voffA);
            PG8_WAIT_V(8); PG8_WAIT_L(0); PG8_BAR; PG8_MMA(1, 0, At, B0); PG8_MMA(1, 1, At, B1); PG8_BAR; PG8_SCHED;
            PG8_LDB(B0, 1, 0); PG8_LDB(B1, 1, 1); PG8_SCHED; PG8_LDA(At, 1, 0); PG8_STAGE(PG8_SA(0, 1), a2 + hstepA, voffA);
            PG8_WAIT_V(8); PG8_WAIT_L(0); PG8_BAR; PG8_MMA(0, 0, At, B0); PG8_MMA(0, 1, At, B1); PG8_BAR; PG8_SCHED;
            PG8_LDA(At, 1, 1); PG8_STAGE(PG8_SB(1, 0), b3, voffB); PG8_STAGE(PG8_SB(1, 1), b3 + hstepB, voffB); PG8_STAGE(PG8_SA(1, 0), a3, voffA);
            PG8_WAIT_V(8); PG8_WAIT_L(0); PG8_BAR; PG8_MMA(1, 0, At, B0); PG8_MMA(1, 1, At, B1); PG8_BAR; PG8_SCHED;
        }
        if (wr == 0) PG8_BAR;
        E(acc, cur, wr, wc, fr, fq);
        if (!has_next) break;
#pragma unroll
        for (int a = 0; a < 2; ++a)
#pragma unroll
            for (int b = 0; b < 2; ++b)
#pragma unroll
                for (int m = 0; m < 4; ++m)
#pragma unroll
                    for (int n = 0; n < 2; ++n) acc[a][b][m][n] = (f32x4){0.f, 0.f, 0.f, 0.f};
        cur = nxt; cA = nA; cB = nB; ++ui;
        if (wr == 1) PG8_BAR;
    }
    PG8_WAIT_V(0);
    PG8_BAR;
#undef PG8_SA
#undef PG8_SB
#undef PG8_STAGE
#undef PG8_LDA
#undef PG8_LDB
#undef PG8_MMA
#undef PG8_WAIT_V
#undef PG8_WAIT_L
#undef PG8_BAR
#undef PG8_SCHED
}

__device__ __forceinline__ void tile_of(int idx, int nM, int nN, int& pm, int& pn) {
    const int nwg = nM * nN; int wgid = idx;
    { const int q = nwg / 8, r = nwg % 8, xcd = wgid % 8, off = wgid / 8; wgid = (xcd < r ? xcd * (q + 1) : r * (q + 1) + (xcd - r) * q) + off; }
    const int nig = 8 * nN, gid = wgid / nig, fm = gid * 8, gsz = (nM - fm) < 8 ? (nM - fm) : 8;
    pm = fm + ((wgid % nig) % gsz); pn = (wgid % nig) / gsz;
}
}

struct OrderIn {
    const bf16_t* H; const bf16_t* W; int nM, n_main, n_extra, G, c;
    __device__ __forceinline__ bool next(int i, pg8::Unit& u) const {
        const int L = i * G + c; int pm, pn;
        if (L < n_main) pg8::tile_of(L, nM, DIN / 256, pm, pn);
        else if (L < n_main + n_extra) { const int e = L - n_main; pm = 32 + (e & 1); pn = C_K / 256 + (e >> 1); }
        else return false;
        u.A = (const char*)(H + (size_t)pm * 256 * DM); u.B = (const char*)(W + (size_t)pn * 256 * DM); u.row0 = pm * 256; u.col0 = pn * 256; return true;
    }
};
struct OrderSq {
    const bf16_t* A; const bf16_t* W; int nM, G, c;
    __device__ __forceinline__ bool next(int i, pg8::Unit& u) const {
        const int L = i * G + c; if (L >= nM * 16) return false;
        int pm, pn; pg8::tile_of(L, nM, 16, pm, pn);
        u.A = (const char*)(A + (size_t)pm * 256 * DM); u.B = (const char*)(W + (size_t)pn * 256 * DM); u.row0 = pm * 256; u.col0 = pn * 256; return true;
    }
};
struct OrderPool {
    const bf16_t* PP; const bf16_t* W; int nM, G, c;
    __device__ __forceinline__ bool next(int i, pg8::Unit& u) const {
        const int L = i * G + c; if (L >= nM * 8) return false;
        const int pm = L >> 3, gn = L & 7;
        u.A = (const char*)(PP + (size_t)pm * 256 * DPOOL + (gn >> 1) * 512); u.B = (const char*)(W + (size_t)gn * 256 * 512); u.row0 = pm * 256; u.col0 = gn * 256; return true;
    }
};

struct EpiIn {
    static constexpr bool PERM = true, MIDK = false;
    bf16_t* P; const float* bias;
    __device__ __forceinline__ void mid(f32x4 (&)[2][2][4][2], const pg8::Unit&, int, int, int, int) const {}
    __device__ __forceinline__ void operator()(const f32x4 (&acc)[2][2][4][2], const pg8::Unit& u, int wr, int wc, int fr, int fq) const {
        const int row0 = u.row0 + wr * 64 + fr, col0 = u.col0 + wc * 32 + 8 * fq;
        const int seg = u.col0 >> 11;
        const int act = (seg == 1 || seg == 5) ? 1 : (seg >= 6 ? 2 : (seg == 2 ? 3 : 0));
        f32x4 bv[2][2];
#pragma unroll
        for (int bj = 0; bj < 2; ++bj)
#pragma unroll
            for (int n = 0; n < 2; ++n) bv[bj][n] = *(const f32x4*)(bias + col0 + bj * 128 + 4 * n);
#pragma unroll
        for (int ai = 0; ai < 2; ++ai)
#pragma unroll
            for (int m = 0; m < 4; ++m) { bf16_t* rowp = P + (size_t)(row0 + ai * 128 + m * 16) * DIN + col0;
#pragma unroll
                for (int bj = 0; bj < 2; ++bj) { f32x4 v0 = acc[ai][bj][m][0] + bv[bj][0], v1 = acc[ai][bj][m][1] + bv[bj][1];
                    if (act == 1) {
#pragma unroll
                        for (int j = 0; j < 4; ++j) { v0[j] = silu_f(v0[j]); v1[j] = silu_f(v1[j]); } }
                    else if (act == 2) {
#pragma unroll
                        for (int j = 0; j < 4; ++j) { v0[j] = sigmoid_f(v0[j]); v1[j] = sigmoid_f(v1[j]); } }
                    else if (act == 3) { v0 = v0 * QSCALE; v1 = v1 * QSCALE; }
                    u32x4 w; w.x = cvt_pk_bf16(v0[0], v0[1]); w.y = cvt_pk_bf16(v0[2], v0[3]); w.z = cvt_pk_bf16(v1[0], v1[1]); w.w = cvt_pk_bf16(v1[2], v1[3]);
                    *(u32x4*)(rowp + bj * 128) = w; } }
    }
};
struct EpiPool {
    static constexpr bool PERM = true, MIDK = false;
    bf16_t* YZ; const bf16_t* P; const float* spool;
    __device__ __forceinline__ void mid(f32x4 (&)[2][2][4][2], const pg8::Unit&, int, int, int, int) const {}
    __device__ __forceinline__ void operator()(const f32x4 (&acc)[2][2][4][2], const pg8::Unit& u, int wr, int wc, int fr, int fq) const {
        const int row0 = u.row0 + wr * 64 + fr, col0 = u.col0 + wc * 32 + 8 * fq;
        f32x4 sv[2][2];
#pragma unroll
        for (int bj = 0; bj < 2; ++bj)
#pragma unroll
            for (int n = 0; n < 2; ++n) sv[bj][n] = *(const f32x4*)(spool + col0 + bj * 128 + 4 * n);
#pragma unroll
        for (int ai = 0; ai < 2; ++ai)
#pragma unroll
            for (int m = 0; m < 4; ++m) { const size_t r = (size_t)(row0 + ai * 128 + m * 16);
#pragma unroll
                for (int bj = 0; bj < 2; ++bj) { const u32x4 z = *(const u32x4*)(P + r * DIN + C_ZP + col0 + bj * 128);
                    const f32x4 v0 = acc[ai][bj][m][0] * sv[bj][0], v1 = acc[ai][bj][m][1] * sv[bj][1];
                    u32x4 w; w.x = cvt_pk_bf16(v0[0] * bf_lo(z.x), v0[1] * bf_hi(z.x)); w.y = cvt_pk_bf16(v0[2] * bf_lo(z.y), v0[3] * bf_hi(z.y));
                    w.z = cvt_pk_bf16(v1[0] * bf_lo(z.z), v1[1] * bf_hi(z.z)); w.w = cvt_pk_bf16(v1[2] * bf_lo(z.w), v1[3] * bf_hi(z.w));
                    *(u32x4*)(YZ + r * DM + col0 + bj * 128) = w; } }
    }
};
struct EpiMerge {
    static constexpr bool PERM = true, MIDK = true;
    bf16_t* MRG; const bf16_t* P;
    __device__ __forceinline__ void mid(f32x4 (&acc)[2][2][4][2], const pg8::Unit& u, int, int, int, int) const {
        int tz = threadIdx.x; asm volatile("" : "+v"(tz));
        const int wid = tz >> 6, lane = tz & 63, wr = wid >> 2, wc = wid & 3, fr = lane & 15, fq = lane >> 4;
        const int row0 = u.row0 + wr * 64 + fr, col0 = u.col0 + wc * 32 + 8 * fq;
#pragma unroll
        for (int ai = 0; ai < 2; ++ai)
#pragma unroll
            for (int m = 0; m < 4; ++m) { const bf16_t* rp = P + (size_t)(row0 + ai * 128 + m * 16) * DIN + col0;
#pragma unroll
                for (int bj = 0; bj < 2; ++bj) { const u32x4 gp = *(const u32x4*)(rp + C_GP + bj * 128), ga = *(const u32x4*)(rp + C_GA + bj * 128);
                    f32x4 r0, r1;
                    r0[0] = bf_lo(gp.x) * __builtin_amdgcn_rcpf(bf_lo(ga.x)); r0[1] = bf_hi(gp.x) * __builtin_amdgcn_rcpf(bf_hi(ga.x));
                    r0[2] = bf_lo(gp.y) * __builtin_amdgcn_rcpf(bf_lo(ga.y)); r0[3] = bf_hi(gp.y) * __builtin_amdgcn_rcpf(bf_hi(ga.y));
                    r1[0] = bf_lo(gp.z) * __builtin_amdgcn_rcpf(bf_lo(ga.z)); r1[1] = bf_hi(gp.z) * __builtin_amdgcn_rcpf(bf_hi(ga.z));
                    r1[2] = bf_lo(gp.w) * __builtin_amdgcn_rcpf(bf_lo(ga.w)); r1[3] = bf_hi(gp.w) * __builtin_amdgcn_rcpf(bf_hi(ga.w));
                    acc[ai][bj][m][0] *= r0; acc[ai][bj][m][1] *= r1; }
                asm volatile("" ::: "memory"); }
    }
    __device__ __forceinline__ void operator()(const f32x4 (&acc)[2][2][4][2], const pg8::Unit& u, int wr, int wc, int fr, int fq) const {
        const int row0 = u.row0 + wr * 64 + fr, col0 = u.col0 + wc * 32 + 8 * fq;
#pragma unroll
        for (int ai = 0; ai < 2; ++ai)
#pragma unroll
            for (int m = 0; m < 4; ++m) { const size_t r = (size_t)(row0 + ai * 128 + m * 16);
#pragma unroll
                for (int bj = 0; bj < 2; ++bj) { const u32x4 ga = *(const u32x4*)(P + r * DIN + C_GA + col0 + bj * 128);
                    const f32x4 v0 = acc[ai][bj][m][0], v1 = acc[ai][bj][m][1];
                    u32x4 w; w.x = cvt_pk_bf16(v0[0] * bf_lo(ga.x), v0[1] * bf_hi(ga.x)); w.y = cvt_pk_bf16(v0[2] * bf_lo(ga.y), v0[3] * bf_hi(ga.y));
                    w.z = cvt_pk_bf16(v1[0] * bf_lo(ga.z), v1[1] * bf_hi(ga.z)); w.w = cvt_pk_bf16(v1[2] * bf_lo(ga.w), v1[3] * bf_hi(ga.w));
                    *(u32x4*)(MRG + r * DM + col0 + bj * 128) = w; }
                asm volatile("" ::: "memory"); }
    }
};
struct EpiOut {
    static constexpr bool PERM = false, MIDK = false;
    const float* xold_lat; const float* xold_ctx; float* xnew_lat; float* xnew_ctx; const float* gt;
    __device__ __forceinline__ void mid(f32x4 (&)[2][2][4][2], const pg8::Unit&, int, int, int, int) const {}
    __device__ __forceinline__ void operator()(const f32x4 (&acc)[2][2][4][2], const pg8::Unit& u, int wr, int wc, int fr, int fq) const {
        const bool isctx = u.row0 >= MLAT;
        const float* xo = isctx ? xold_ctx + (size_t)(u.row0 - MLAT) * DM : xold_lat + (size_t)u.row0 * DM;
        float* xn = isctx ? xnew_ctx + (size_t)(u.row0 - MLAT) * DM : xnew_lat + (size_t)u.row0 * DM;
        const float* g = gt + (isctx ? 2 : (u.row0 >> 12)) * DM;
        const int rl = wr * 64 + fr, col0 = u.col0 + wc * 32 + 4 * fq;
        f32x4 gv[2][2];
#pragma unroll
        for (int bj = 0; bj < 2; ++bj)
#pragma unroll
            for (int n = 0; n < 2; ++n) gv[bj][n] = *(const f32x4*)(g + col0 + bj * 128 + n * 16);
#pragma unroll
        for (int ai = 0; ai < 2; ++ai)
#pragma unroll
            for (int m = 0; m < 4; ++m) { const size_t off = (size_t)(rl + ai * 128 + m * 16) * DM + col0;
#pragma unroll
                for (int bj = 0; bj < 2; ++bj)
#pragma unroll
                    for (int n = 0; n < 2; ++n) { const f32x4 xb = *(const f32x4*)(xo + off + bj * 128 + n * 16);
                        *(f32x4*)(xn + off + bj * 128 + n * 16) = xb + gv[bj][n] * acc[ai][bj][m][n]; }
                asm volatile("" ::: "memory"); }
    }
};

namespace att {
constexpr int SHM_V = 16384, SHM_K = 16384;
constexpr int OFF_V = 0, OFF_K = 2 * SHM_V, OFF_WS = NWAVES * 8704  , OFF_BIAS = OFF_WS + NWAVES * 256, BIAS_LD = 128;
static_assert(OFF_WS >= OFF_K + 2 * SHM_K && OFF_BIAS + 15 * BIAS_LD * 4 <= RING_BYTES, "attention LDS map");
#define KSWZ(row, colB) ((row) * 256 + ((colB) ^ (((row) & 7) << 4)))
#define SBAR() __builtin_amdgcn_sched_barrier(0)
__device__ __forceinline__ int crow(int r, int hi) { return (r & 3) + 8 * (r >> 2) + 4 * hi; }
__device__ __forceinline__ void qkt(f32x16& p0, f32x16& p1, const char* Ks, const bf16x8* qr, int r32, int hi) {
    p0 = f32x16{}; p1 = f32x16{};
#pragma unroll
    for (int d0 = 0; d0 < 8; ++d0) { const int cb = (d0 * 16 + hi * 8) * 2;
        const bf16x8 b0 = *reinterpret_cast<const bf16x8*>(Ks + KSWZ(r32, cb));
        const bf16x8 b1 = *reinterpret_cast<const bf16x8*>(Ks + KSWZ(32 + r32, cb));
        p0 = __builtin_amdgcn_mfma_f32_32x32x16_bf16(b0, qr[d0], p0, 0, 0, 0);
        p1 = __builtin_amdgcn_mfma_f32_32x32x16_bf16(b1, qr[d0], p1, 0, 0, 0); }
}
__device__ __forceinline__ int v_st(int k, int c) { const int kk = (k & ~0xC) | ((k & 4) << 1) | ((k & 8) >> 1); return ((kk >> 3) * 4 + (c >> 5)) * 512 + ((kk & 7) * 32 + (c & 31)) * 2; }
__device__ __forceinline__ int v_rd_base(int lane) { return ((lane & 3) << 3) | (((lane >> 2) & 3) << 6) | (((lane >> 4) & 1) << 5) | (((lane >> 5) & 1) << 8); }
constexpr int v_rd_off(int d0, int ks, int half) { return d0 * 512 + ks * 4096 + half * 2048; }
template <int OFF> __device__ __forceinline__ s16x4 tr_read(int vb) {
    s16x4 r; asm volatile("ds_read_b64_tr_b16 %0, %1 offset:%2" : "=&v"(r) : "v"(vb), "i"(OFF) : "memory"); return r;
}
template <int D0> __device__ __forceinline__ void pv_one(f32x16& od, int vb, bf16x8 pa0, bf16x8 pa1, bf16x8 pa2, bf16x8 pa3) {
    const s16x4 l0 = tr_read<v_rd_off(D0, 0, 0)>(vb), h0 = tr_read<v_rd_off(D0, 0, 1)>(vb), l1 = tr_read<v_rd_off(D0, 1, 0)>(vb), h1 = tr_read<v_rd_off(D0, 1, 1)>(vb);
    const s16x4 l2 = tr_read<v_rd_off(D0, 2, 0)>(vb), h2 = tr_read<v_rd_off(D0, 2, 1)>(vb), l3 = tr_read<v_rd_off(D0, 3, 0)>(vb), h3 = tr_read<v_rd_off(D0, 3, 1)>(vb);
    asm volatile("s_waitcnt lgkmcnt(0)" ::: "memory"); SBAR();
#define PK(L, H) (bf16x8){L[0], L[1], L[2], L[3], H[0], H[1], H[2], H[3]}
    od = __builtin_amdgcn_mfma_f32_32x32x16_bf16(pa0, PK(l0, h0), od, 0, 0, 0);
    od = __builtin_amdgcn_mfma_f32_32x32x16_bf16(pa1, PK(l1, h1), od, 0, 0, 0);
    od = __builtin_amdgcn_mfma_f32_32x32x16_bf16(pa2, PK(l2, h2), od, 0, 0, 0);
    od = __builtin_amdgcn_mfma_f32_32x32x16_bf16(pa3, PK(l3, h3), od, 0, 0, 0);
#undef PK
}
__device__ __forceinline__ void pv_d0(f32x16* o, int vb, bf16x8 pa0, bf16x8 pa1, bf16x8 pa2, bf16x8 pa3) {
    pv_one<0>(o[0], vb, pa0, pa1, pa2, pa3); pv_one<1>(o[1], vb, pa0, pa1, pa2, pa3); pv_one<2>(o[2], vb, pa0, pa1, pa2, pa3); pv_one<3>(o[3], vb, pa0, pa1, pa2, pa3);
}
__device__ __forceinline__ void softmax_tile(f32x16& p0, f32x16& p1, float& m_reg, float& l_reg, f32x16* o, float* al_l, int r32, int hi,
                                             bf16x8& pa0, bf16x8& pa1, bf16x8& pa2, bf16x8& pa3) {
    float pmax = p0[0];
#pragma unroll
    for (int r = 1; r < 16; ++r) pmax = fmaxf(pmax, p0[r]);
#pragma unroll
    for (int r = 0; r < 16; ++r) pmax = fmaxf(pmax, p1[r]);
    { auto rr = __builtin_amdgcn_permlane32_swap(__float_as_uint(pmax), __float_as_uint(pmax), false, false);
      pmax = fmaxf(__uint_as_float(rr[0]), __uint_as_float(rr[1])); }
    float alpha = 1.f;
    if (!__all(pmax <= m_reg)) { const float mn = fmaxf(m_reg, pmax); alpha = __builtin_amdgcn_exp2f(m_reg - mn); m_reg = mn;
        if (hi == 0) al_l[r32] = alpha; asm volatile("s_waitcnt lgkmcnt(0)" ::: "memory");
#pragma unroll
        for (int d = 0; d < 4; ++d)
#pragma unroll
            for (int r = 0; r < 16; ++r) o[d][r] *= al_l[crow(r, hi)];
    }
    float ps = 0.f;
#pragma unroll
    for (int r = 0; r < 16; ++r) { p0[r] = __builtin_amdgcn_exp2f(p0[r] - m_reg); ps += p0[r]; }
#pragma unroll
    for (int r = 0; r < 16; ++r) { p1[r] = __builtin_amdgcn_exp2f(p1[r] - m_reg); ps += p1[r]; }
    { auto rr = __builtin_amdgcn_permlane32_swap(__float_as_uint(ps), __float_as_uint(ps), false, false);
      ps = __uint_as_float(rr[0]) + __uint_as_float(rr[1]); }
    l_reg = l_reg * alpha + ps;
#define PK4(P, BASE, OUT) do { unsigned a0 = cvt_pk_bf16(P[BASE + 0], P[BASE + 1]), a1 = cvt_pk_bf16(P[BASE + 2], P[BASE + 3]);   \
    unsigned b0 = cvt_pk_bf16(P[BASE + 4], P[BASE + 5]), b1 = cvt_pk_bf16(P[BASE + 6], P[BASE + 7]);                              \
    auto r0 = __builtin_amdgcn_permlane32_swap(a0, b0, false, false); auto r1 = __builtin_amdgcn_permlane32_swap(a1, b1, false, false); \
    u32x4 w = {r0[0], r1[0], r0[1], r1[1]}; OUT = *reinterpret_cast<bf16x8*>(&w); } while (0)
    PK4(p0, 0, pa0); PK4(p0, 8, pa1); PK4(p1, 0, pa2); PK4(p1, 8, pa3);
#undef PK4
}

__device__ __forceinline__ void attn_unit(char* lds, const bf16_t* __restrict__ P, bf16_t* __restrict__ YZ, const float* __restrict__ rpb, int b, int h, int band) {
    int tid = threadIdx.x; asm volatile("" : "+v"(tid));
    const int wid = __builtin_amdgcn_readfirstlane(tid >> 6), lane = tid & 63, r32 = lane & 31, hi = lane >> 5;
    char* V_lds = lds + OFF_V; char* K_lds = lds + OFF_K;
    float* wsf = (float*)(lds + OFF_WS) + wid * 64; float* li_l = wsf; float* al_l = wsf + 32;
    float* btab = (float*)(lds + OFF_BIAS);
    const bool isctx = band < 0;
    if (!isctx) { for (int i = tid; i < 15 * 31; i += NWAVES * 64) { const int dr = i / 31, rel = i - dr * 31; btab[dr * BIAS_LD + 48 + rel] = rpb[(h * 15 + dr) * 31 + rel] * LOG2E; } }
    int qrow = 0, qc = 0, klo = 0, nloc = 0, rs = 0; size_t qtok;
    if (!isctx) { qrow = 4 * band + (wid >> 1); qc = 32 * (wid & 1) + r32; qtok = (size_t)b * SEQ + qrow * GW + qc;
        const int a0 = 4 * band - 4, a1 = 4 * band - 1; klo = a0 < 0 ? 0 : (a0 > 56 ? 56 : a0); const int khi = (a1 < 0 ? 0 : (a1 > 56 ? 56 : a1)) + 7; nloc = khi - klo + 1;
        const int r4 = qrow - 4; rs = r4 < 0 ? 0 : (r4 > 56 ? 56 : r4); }
    else { qtok = (size_t)MLAT + b * CTX + 32 * wid + r32; }
    const int NT = nloc + 4;
    const int wsc = qc - 8 < 0 ? 0 : (qc - 8 > 48 ? 48 : qc - 8);
    const int e_m = 4 * hi - wsc;
    const int bbase = 63 + 4 * hi - qc;
    bf16x8 qr[8];
    { const bf16_t* Qw = P + qtok * DIN + C_Q + h * HD + hi * 8;
#pragma unroll
      for (int d0 = 0; d0 < 8; ++d0) qr[d0] = *reinterpret_cast<const bf16x8*>(Qw + d0 * 16); }
    float m_reg = -1e30f, l_reg = 0.f; f32x16 o[4] = {};
    const int sr = tid >> 4, sc = (tid & 15) * 8, vst0 = v_st(sr, sc), vst1 = v_st(32 + sr, sc);
    const int vb0 = (int)(uintptr_t)V_lds + v_rd_base(lane);
    bf16x8 sk0, sk1, sv0, sv1;
    const size_t ctx0 = (size_t)MLAT + (size_t)b * CTX;
#define TILE_ROW0(j) ((j) < nloc ? ((size_t)b * SEQ + (size_t)(klo + (j)) * GW) : (ctx0 + (size_t)((j) - nloc) * 64))
#define SLOAD(j) do { const bf16_t* kp = P + (TILE_ROW0(j) + sr) * DIN + h * HD + sc; \
        sk0 = *reinterpret_cast<const bf16x8*>(kp + C_K); sk1 = *reinterpret_cast<const bf16x8*>(kp + C_K + (size_t)32 * DIN); \
        sv0 = *reinterpret_cast<const bf16x8*>(kp + C_V); sv1 = *reinterpret_cast<const bf16x8*>(kp + C_V + (size_t)32 * DIN); } while (0)
#define SWRITE(bf) do { *(bf16x8*)(V_lds + (bf) * SHM_V + vst0) = sv0; *(bf16x8*)(V_lds + (bf) * SHM_V + vst1) = sv1; \
        *(bf16x8*)(K_lds + (bf) * SHM_K + KSWZ(sr, sc * 2)) = sk0; *(bf16x8*)(K_lds + (bf) * SHM_K + KSWZ(32 + sr, sc * 2)) = sk1; } while (0)
    SLOAD(0); SWRITE(0); __syncthreads();
    for (int j = 0; j < NT; ++j) {
        const int bf = j & 1;
        if (j + 1 < NT) SLOAD(j + 1);
        const bool local = j < nloc; const int dr = klo + j - rs;
        const bool active = !local || (dr >= 0 && dr < 8);
        if (active) {
            f32x16 p0, p1; bf16x8 pa0, pa1, pa2, pa3;
            qkt(p0, p1, K_lds + bf * SHM_K, qr, r32, hi);
            if (local) { const float* brow = btab + (klo + j - qrow + 7) * BIAS_LD + bbase;
#pragma unroll
                for (int r = 0; r < 16; ++r) { const int kc0 = (r & 3) + 8 * (r >> 2);
                    p0[r] = ((unsigned)(kc0 + e_m) < 16u) ? p0[r] + brow[kc0] : -1e30f;
                    p1[r] = ((unsigned)(kc0 + 32 + e_m) < 16u) ? p1[r] + brow[kc0 + 32] : -1e30f; } }
            softmax_tile(p0, p1, m_reg, l_reg, o, al_l, r32, hi, pa0, pa1, pa2, pa3);
            pv_d0(o, vb0 + bf * SHM_V, pa0, pa1, pa2, pa3);
        }
        if (j + 1 < NT) SWRITE(bf ^ 1);
        __syncthreads();
    }
#undef SLOAD
#undef SWRITE
#undef TILE_ROW0
    if (hi == 0) li_l[r32] = l_reg; asm volatile("s_waitcnt lgkmcnt(0)" ::: "memory");
    char* ot = lds + wid * 8704;
#pragma unroll
    for (int r = 0; r < 16; ++r) { const int orow = crow(r, hi); const float rl = __builtin_amdgcn_rcpf(li_l[orow]);
#pragma unroll
        for (int d0 = 0; d0 < 4; ++d0) { const float v = o[d0][r] * rl; *(bf16_t*)(ot + orow * 272 + (d0 * 32 + r32) * 2) = (bf16_t)(cvt_pk_bf16(v, v) & 0xffffu); } }
    asm volatile("s_waitcnt lgkmcnt(0)" ::: "memory");
    const size_t tok0 = qtok - r32;
    { const int ch = lane & 15, q0 = lane >> 4;
#pragma unroll
      for (int i = 0; i < 8; ++i) { const int q = q0 + 4 * i; const u32x4 ov = *(const u32x4*)(ot + q * 272 + ch * 16);
          const u32x4 z = *(const u32x4*)(P + (tok0 + q) * DIN + C_ZA + h * HD + ch * 8);
          u32x4 w; w.x = cvt_pk_bf16(bf_lo(ov.x) * bf_lo(z.x), bf_hi(ov.x) * bf_hi(z.x)); w.y = cvt_pk_bf16(bf_lo(ov.y) * bf_lo(z.y), bf_hi(ov.y) * bf_hi(z.y));
          w.z = cvt_pk_bf16(bf_lo(ov.z) * bf_lo(z.z), bf_hi(ov.z) * bf_hi(z.z)); w.w = cvt_pk_bf16(bf_lo(ov.w) * bf_lo(z.w), bf_hi(ov.w) * bf_hi(z.w));
          *(u32x4*)(YZ + (tok0 + q) * DM + DPOOL + h * HD + ch * 8) = w; } }
    __syncthreads();
}
}

#define XB_TMO      128
#define XB_XCNT(j)  (256  + 64 * (j))
#define XB_XSUB(j)  (1280 + 64 * (j))
#define XB_XGEN(j)  (2304 + 64 * (j))
#define XB_TOP      3328
#define XB_TOPGEN   3392
#define XCD_BAR_WORDS 3456
#define XB_SPIN_CAP (1u << 18)
__device__ __forceinline__ unsigned xb_ld(unsigned* p)              { return __hip_atomic_load(p, __ATOMIC_RELAXED, __HIP_MEMORY_SCOPE_AGENT); }
__device__ __forceinline__ unsigned xb_add(unsigned* p, unsigned v) { return __hip_atomic_fetch_add(p, v, __ATOMIC_RELAXED, __HIP_MEMORY_SCOPE_AGENT); }
__device__ __forceinline__ unsigned xb_xcc_id() { return (unsigned)__builtin_amdgcn_s_getreg((3 << 11) | 20) & 0xFu; }
#define XB_SPIN(cond, bar) do { unsigned _sp = 0; while (cond) { __builtin_amdgcn_s_sleep(1); \
    if ((++_sp & 255u) == 0u) { if (xb_ld(&(bar)[XB_TMO])) break; if (_sp > XB_SPIN_CAP) { atomicAdd(&(bar)[XB_TMO], 1u); break; } } } } while (0)
struct XcdBarrier { unsigned* bar; unsigned x; volatile LAS unsigned* st; };
__device__ __forceinline__ XcdBarrier xcd_barrier_post(unsigned* bar, volatile LAS unsigned* st) {
    XcdBarrier b; b.bar = bar; b.x = xb_xcc_id(); b.st = st;
    if (threadIdx.x == 0) (void)xb_add(&bar[XB_XCNT(b.x)], 1u);
    return b;
}
__device__ __forceinline__ void xcd_barrier_complete(unsigned* bar, unsigned x, unsigned& nloc, unsigned& nx) {
    const unsigned G = gridDim.x * gridDim.y * gridDim.z;
    unsigned sum, cnt, mine, sp = 0u;
    for (;;) {
        sum = 0u; cnt = 0u; mine = 0u;
#pragma unroll
        for (unsigned j = 0; j < 16; ++j) { const unsigned c = xb_ld(&bar[XB_XCNT(j)]); sum += c; cnt += (c > 0u) ? 1u : 0u; mine = (j == x) ? c : mine; }
        if (sum == G) break;
        __builtin_amdgcn_s_sleep(1);
        if ((++sp & 255u) == 0u) { if (xb_ld(&bar[XB_TMO])) break; if (sp > XB_SPIN_CAP) { atomicAdd(&bar[XB_TMO], 1u); break; } }
    }
    nloc = mine > 0u ? mine : 1u; nx = cnt > 0u ? cnt : 1u;
}
__device__ __forceinline__ void xcd_barrier(const XcdBarrier& b) {
    asm volatile("s_waitcnt vmcnt(0)" ::: "memory");
    __syncthreads();
    if (threadIdx.x == 0) {
        unsigned* bar = b.bar;
        __builtin_amdgcn_s_waitcnt(0);
        unsigned nloc = b.st[0], nx = b.st[1];
        if (nloc == 0u) { xcd_barrier_complete(bar, b.x, nloc, nx); b.st[0] = nloc; b.st[1] = nx; }
        const unsigned old = xb_add(&bar[XB_XSUB(b.x)], 1u);
        const unsigned gen = old / nloc;
        if (old + 1u == (gen + 1u) * nloc) {
            __builtin_amdgcn_fence(__ATOMIC_RELEASE, "agent");
            asm volatile("s_waitcnt vmcnt(0)" ::: "memory");
            const unsigned og = xb_add(&bar[XB_TOP], 1u);
            const unsigned tg = og / nx;
            if (og + 1u == (tg + 1u) * nx) xb_add(&bar[XB_TOPGEN], 1u);
            else XB_SPIN(xb_ld(&bar[XB_TOPGEN]) == tg, bar);
            __builtin_amdgcn_fence(__ATOMIC_ACQUIRE, "agent");
            xb_add(&bar[XB_XGEN(b.x)], 1u);
            asm volatile("s_waitcnt vmcnt(0)" ::: "memory");
        } else {
            XB_SPIN(xb_ld(&bar[XB_XGEN(b.x)]) == gen, bar);
            __builtin_amdgcn_fence(__ATOMIC_ACQUIRE, "agent");
            asm volatile("s_waitcnt vmcnt(0)" ::: "memory");
        }
    }
    __syncthreads();
}

struct Args { const float* in[16]; float* out; unsigned char* ws; int ph_lo, ph_hi; };
struct Frame {
    LAS unsigned char* lds; unsigned char* ldsg;
    int tid, lane, wave, vcu, G;
    const float *x, *c, *ctx, *c_ctx, *norm_g, *w_ada, *b_ada, *w_in, *b_in, *w_pool, *s_pool, *rpb, *w_br_pool, *w_br_attn, *w_out, *final_g;
    float* out;
    float *ADAP, *GT, *XL, *XC;
    bf16_t *WPOOL, *WIN, *WBR, *WOUT, *H, *P, *PP, *YZ, *MRG;
};

__device__ __forceinline__ void p0_transpose_item(const float* W, int N, bf16_t* WT, int ldt, LAS float* scr, int item, int lane) {
    const int nblk = N / 32, kb = item / nblk, nb = item - kb * nblk, k0 = 64 * kb, n0 = 32 * nb;
    const float* src = W + (size_t)(k0 + (lane >> 3)) * N + n0 + 4 * (lane & 7);
    f32x4 v[8];
#pragma unroll
    for (int i = 0; i < 8; ++i) v[i] = *(const f32x4*)(src + (size_t)(8 * i) * N);
#pragma unroll
    for (int i = 0; i < 8; ++i) { LAS float* d = scr + (8 * i + (lane >> 3)) * 33 + 4 * (lane & 7); d[0] = v[i][0]; d[1] = v[i][1]; d[2] = v[i][2]; d[3] = v[i][3]; }
    LDS_WAIT(); asm volatile("" ::: "memory");
    const int c = lane & 7;
#pragma unroll
    for (int j = 0; j < 4; ++j) { const int n = (lane >> 3) + 8 * j; const LAS float* s = scr + (8 * c) * 33 + n;
        u32x4 o; o.x = cvt_pk_bf16(s[0 * 33], s[1 * 33]); o.y = cvt_pk_bf16(s[2 * 33], s[3 * 33]); o.z = cvt_pk_bf16(s[4 * 33], s[5 * 33]); o.w = cvt_pk_bf16(s[6 * 33], s[7 * 33]);
        *(u32x4*)(WT + (size_t)(n0 + n) * ldt + k0 + 8 * c) = o; }
    LDS_WAIT(); asm volatile("" ::: "memory");
}
__device__ __forceinline__ void p0_prologue(Frame& F) {
    LAS float* st = (LAS float*)F.lds;
    LAS float* red = (LAS float*)(F.lds + 49152);
    for (int i = F.tid; i < 3 * DM; i += NWAVES * 64) { const int ty = i >> 12, k = i & (DM - 1); const float v = ty < 2 ? F.c[ty * DM + k] : F.c_ctx[k]; st[i] = silu_f(v); }
    __syncthreads();
    for (int it = F.vcu; it < NL * 48 * ADA_KS; it += F.G) {
        const int l = it / (48 * ADA_KS), rem = it - l * 48 * ADA_KS, ns = rem / ADA_KS, ks = rem - ns * ADA_KS;
        const int k0 = ks * 512 + F.wave * 64;
        const float* W = F.w_ada + ((size_t)l * DM + k0) * ADA_N + ns * 256 + F.lane * 4;
        f32x4 a0 = {0.f, 0.f, 0.f, 0.f}, a1 = a0, a2 = a0;
#pragma unroll 8
        for (int kk = 0; kk < 64; ++kk) { const f32x4 w = *(const f32x4*)(W + (size_t)kk * ADA_N); const float s0 = st[k0 + kk], s1 = st[DM + k0 + kk], s2 = st[2 * DM + k0 + kk];
            a0 += w * s0; a1 += w * s1; a2 += w * s2; }
        *(LAS f32x4*)(red + (F.wave * 3 + 0) * 256 + F.lane * 4) = a0; *(LAS f32x4*)(red + (F.wave * 3 + 1) * 256 + F.lane * 4) = a1; *(LAS f32x4*)(red + (F.wave * 3 + 2) * 256 + F.lane * 4) = a2;
        __syncthreads();
        if (F.tid < 192) { const int ty = F.tid >> 6, ln = F.tid & 63; f32x4 s = {0.f, 0.f, 0.f, 0.f};
#pragma unroll
            for (int w = 0; w < 8; ++w) s += *(LAS f32x4*)(red + (w * 3 + ty) * 256 + ln * 4);
            *(f32x4*)(F.ADAP + (((size_t)l * ADA_KS + ks) * 3 + ty) * ADA_N + ns * 256 + ln * 4) = s; }
        __syncthreads();
    }
    LAS float* scr = (LAS float*)(F.lds + 73728 + F.wave * 8704);
    const int gw = F.vcu * NWAVES + F.wave, NGW = F.G * NWAVES;
    constexpr int I_IN = (DM / 64) * (DIN / 32), I_BR = (DPOOL / 64) * (DM / 32), I_OUT = (DM / 64) * (DM / 32), I_PL = (512 / 64) * (512 / 32);
    constexpr int I_LAYER = I_IN + 2 * I_BR + I_OUT + 4 * I_PL;
    for (int it = gw; it < NL * I_LAYER; it += NGW) {
        const int l = it / I_LAYER; int r = it - l * I_LAYER;
        if (r < I_IN) { p0_transpose_item(F.w_in + (size_t)l * DM * DIN, DIN, F.WIN + (size_t)l * DIN * DM, DM, scr, r, F.lane); continue; } r -= I_IN;
        if (r < I_BR) { p0_transpose_item(F.w_br_pool + (size_t)l * DPOOL * DM, DM, F.WBR + (size_t)l * DM * DM, DM, scr, r, F.lane); continue; } r -= I_BR;
        if (r < I_BR) { p0_transpose_item(F.w_br_attn + (size_t)l * DATT * DM, DM, F.WBR + (size_t)l * DM * DM + DPOOL, DM, scr, r, F.lane); continue; } r -= I_BR;
        if (r < I_OUT) { p0_transpose_item(F.w_out + (size_t)l * DM * DM, DM, F.WOUT + (size_t)l * DM * DM, DM, scr, r, F.lane); continue; } r -= I_OUT;
        { const int g = r / I_PL; r -= g * I_PL; p0_transpose_item(F.w_pool + ((size_t)l * 4 + g) * 512 * 512, 512, F.WPOOL + ((size_t)l * 4 + g) * 512 * 512, 512, scr, r, F.lane); }
    }
}
__device__ __forceinline__ float ada_sum(const Frame& F, int l, int ty, int n) {
    float s = F.b_ada[(size_t)l * ADA_N + n];
#pragma unroll
    for (int ks = 0; ks < ADA_KS; ++ks) s += F.ADAP[(((size_t)l * ADA_KS + ks) * 3 + ty) * ADA_N + n];
    return s;
}
__device__ __forceinline__ void p1_norm(Frame& F, int l) {
    LAS float* av = (LAS float*)F.lds; LAS float* bv = av + DM;
    if (blockIdx.x < 3) { for (int n = F.tid; n < DM; n += NWAVES * 64) F.GT[((size_t)l * 3 + blockIdx.x) * DM + n] = ada_sum(F, l, blockIdx.x, 2 * DM + n); }
    const int rows_per = (MTOT + F.G - 1) / F.G, rb = F.vcu * rows_per, re = (rb + rows_per) < MTOT ? (rb + rows_per) : MTOT;
    for (int ty = 0; ty < 3; ++ty) {
        const int tlo = ty == 0 ? 0 : (ty == 1 ? SEQ : MLAT), thi = ty == 0 ? SEQ : (ty == 1 ? MLAT : MTOT);
        const int lo = rb > tlo ? rb : tlo, hi = re < thi ? re : thi;
        if (lo >= hi) continue;
        __syncthreads();
        for (int n = F.tid; n < DM; n += NWAVES * 64) { av[n] = F.norm_g[(size_t)l * DM + n] * (1.0f + ada_sum(F, l, ty, DM + n)); bv[n] = ada_sum(F, l, ty, n); }
        __syncthreads();
        for (int row = lo + F.wave; row < hi; row += NWAVES) {
            const float* xr = (l == 0) ? (row < MLAT ? F.x + (size_t)row * DM : F.ctx + (size_t)(row - MLAT) * DM) : (row < MLAT ? F.XL + (size_t)row * DM : F.XC + (size_t)(row - MLAT) * DM);
            f32x4 v[16]; float ss = 0.f;
#pragma unroll
            for (int j = 0; j < 16; ++j) { v[j] = *(const f32x4*)(xr + j * 256 + F.lane * 4); ss += (v[j].x * v[j].x + v[j].y * v[j].y) + (v[j].z * v[j].z + v[j].w * v[j].w); }
            const float rsd = __builtin_amdgcn_rsqf(wave_sum(ss) * (1.0f / DM) + RMS_EPS);
            bf16_t* hr = F.H + (size_t)row * DM;
#pragma unroll
            for (int j = 0; j < 16; ++j) { const f32x4 a = *(LAS f32x4*)(av + j * 256 + F.lane * 4), b = *(LAS f32x4*)(bv + j * 256 + F.lane * 4);
                const f32x4 y = v[j] * rsd * a + b; u32x2 w; w.x = cvt_pk_bf16(y.x, y.y); w.y = cvt_pk_bf16(y.z, y.w); *(u32x2*)(hr + j * 256 + F.lane * 4) = w; }
        }
    }
}
__device__ __forceinline__ void p3_poolprep(Frame& F, int nrows) {
    const int c8 = F.tid & 255, g = c8 >> 6, w = 2 << g, half = w >> 1;
    for (int row = F.vcu * 2 + (F.tid >> 8); row < nrows; row += F.G * 2) {
        const int s0 = row < MLAT ? (row & ~(SEQ - 1)) : (MLAT + ((row - MLAT) & ~(CTX - 1))), len = row < MLAT ? SEQ : CTX, t = row - s0;
        int lo = t - half, hi = t - half + w - 1; lo = lo < 0 ? 0 : lo; hi = hi > len - 1 ? len - 1 : hi;
        float a[8] = {0.f, 0.f, 0.f, 0.f, 0.f, 0.f, 0.f, 0.f};
        for (int r = lo; r <= hi; ++r) { const u32x4 u = *(const u32x4*)(F.P + (size_t)(s0 + r) * DIN + C_U + c8 * 8);
            a[0] += bf_lo(u.x); a[1] += bf_hi(u.x); a[2] += bf_lo(u.y); a[3] += bf_hi(u.y); a[4] += bf_lo(u.z); a[5] += bf_hi(u.z); a[6] += bf_lo(u.w); a[7] += bf_hi(u.w); }
        const float inv = 1.0f / (float)(hi - lo + 1);
        const u32x4 u = *(const u32x4*)(F.P + (size_t)row * DIN + C_U + c8 * 8);
        u32x4 o; o.x = cvt_pk_bf16(a[0] * inv - bf_lo(u.x), a[1] * inv - bf_hi(u.x)); o.y = cvt_pk_bf16(a[2] * inv - bf_lo(u.y), a[3] * inv - bf_hi(u.y));
        o.z = cvt_pk_bf16(a[4] * inv - bf_lo(u.z), a[5] * inv - bf_hi(u.z)); o.w = cvt_pk_bf16(a[6] * inv - bf_lo(u.w), a[7] * inv - bf_hi(u.w));
        *(u32x4*)(F.PP + (size_t)row * DPOOL + c8 * 8) = o;
    }
}
__device__ __forceinline__ void p_final(Frame& F) {
    const int gw = F.vcu * NWAVES + F.wave, NGW = F.G * NWAVES;
    for (int row = gw; row < MLAT; row += NGW) {
        float* xr = F.out + (size_t)row * DM;
        f32x4 v[16]; float ss = 0.f;
#pragma unroll
        for (int j = 0; j < 16; ++j) { v[j] = *(const f32x4*)(xr + j * 256 + F.lane * 4); ss += (v[j].x * v[j].x + v[j].y * v[j].y) + (v[j].z * v[j].z + v[j].w * v[j].w); }
        const float rsd = __builtin_amdgcn_rsqf(wave_sum(ss) * (1.0f / DM) + RMS_EPS);
#pragma unroll
        for (int j = 0; j < 16; ++j) { const f32x4 g = *(const f32x4*)(F.final_g + j * 256 + F.lane * 4); *(f32x4*)(xr + j * 256 + F.lane * 4) = v[j] * rsd * g; }
    }
}

constexpr int N_PHASES = 1 + 6 * NL + 1;
__global__ void __launch_bounds__(NWAVES * 64, 2) mk_fwd(Args args) {
    extern __shared__ __attribute__((aligned(16))) unsigned char lds[];
    Frame F;
    F.lds = (LAS unsigned char*)lds; F.ldsg = lds;
    F.tid = threadIdx.x; F.lane = F.tid & 63; F.wave = __builtin_amdgcn_readfirstlane(F.tid >> 6);
    F.G = gridDim.x; { const int bx = blockIdx.x; F.vcu = (F.G % 8 == 0) ? (bx % 8) * (F.G / 8) + bx / 8 : bx; }
    unsigned char* ws = args.ws;
    F.x = args.in[0]; F.c = args.in[1]; F.ctx = args.in[2]; F.c_ctx = args.in[3]; F.norm_g = args.in[4]; F.w_ada = args.in[5]; F.b_ada = args.in[6]; F.w_in = args.in[7];
    F.b_in = args.in[8]; F.w_pool = args.in[9]; F.s_pool = args.in[10]; F.rpb = args.in[11]; F.w_br_pool = args.in[12]; F.w_br_attn = args.in[13]; F.w_out = args.in[14]; F.final_g = args.in[15];
    F.out = args.out;
    F.ADAP = (float*)(ws + WS_ADAP); F.GT = (float*)(ws + WS_GT); F.XL = (float*)(ws + WS_XL); F.XC = (float*)(ws + WS_XC);
    F.WPOOL = (bf16_t*)(ws + WS_WPOOL); F.WIN = (bf16_t*)(ws + WS_WIN); F.WBR = (bf16_t*)(ws + WS_WBR); F.WOUT = (bf16_t*)(ws + WS_WOUT);
    F.H = (bf16_t*)(ws + WS_H); F.P = (bf16_t*)(ws + WS_P); F.PP = (bf16_t*)(ws + WS_PP); F.YZ = (bf16_t*)(ws + WS_YZ); F.MRG = (bf16_t*)(ws + WS_MRG);
    volatile LAS unsigned* MISC = (volatile LAS unsigned*)(F.lds + MISC_OFF);
    if (F.tid < 64) MISC[F.tid] = 0u;
    __syncthreads();
    unsigned* ctl = (unsigned*)(ws + WS_CTL);
    XcdBarrier bar; bar.bar = ctl + CW_BAR; bar.x = 0; bar.st = nullptr;
    if (MK_N_LAUNCHES == 1) bar = xcd_barrier_post(ctl + CW_BAR, MISC + 8);
    const int lo = args.ph_lo, hi = args.ph_hi;
#ifndef PH_MASK
#define PH_MASK 0x3ff
#endif
#define IN(k) (lo <= (k) && (k) < hi)
#define SEAM(k) do { if (MK_N_LAUNCHES == 1 && IN(k) && IN((k) + 1)) xcd_barrier(bar); } while (0)

    if ((PH_MASK & 1) && IN(0)) { p0_prologue(F); }
    SEAM(0);
    for (int l = 0; l < NL; ++l) {
        const int pb = 1 + 6 * l;
        const bool lastl = (l == NL - 1);
        const int nMfull = lastl ? MLAT / 256 : MTOT / 256;
        if ((PH_MASK & 2) && IN(pb + 0)) { p1_norm(F, l); }
        SEAM(pb + 0);
        if ((PH_MASK & 4) && IN(pb + 1)) {
            OrderIn S; S.H = F.H; S.W = F.WIN + (size_t)l * DIN * DM; S.nM = nMfull; S.n_main = nMfull * (DIN / 256); S.n_extra = lastl ? 2 * (2 * DATT / 256) : 0; S.G = F.G; S.c = (int)blockIdx.x;
            EpiIn E; E.P = F.P; E.bias = F.b_in + (size_t)l * DIN;
            pg8::gemm_phase<EpiIn, OrderIn>(F.lds, DM, DM, DM, S, E);
        }
        SEAM(pb + 1);
        if ((PH_MASK & 8) && IN(pb + 2)) { p3_poolprep(F, nMfull * 256); }
        SEAM(pb + 2);
        if ((PH_MASK & 16) && IN(pb + 3)) {
            if (PH_MASK & 256) { OrderPool S; S.PP = F.PP; S.W = F.WPOOL + (size_t)l * 4 * 512 * 512; S.nM = nMfull; S.G = F.G; S.c = F.vcu;
              EpiPool E; E.YZ = F.YZ; E.P = F.P; E.spool = F.s_pool + (size_t)l * DPOOL;
              pg8::gemm_phase<EpiPool, OrderPool>(F.lds, DPOOL, 512, 512, S, E); }
            __syncthreads();
            const int n_units = NB * NH * 16 + (lastl ? 0 : NB * NH);
            if (PH_MASK & 512) for (int u = F.vcu; u < n_units; u += F.G) {
                const bool lat = u < NB * NH * 16; const int v = u - NB * NH * 16;
                att::attn_unit((char*)F.ldsg, F.P, F.YZ, F.rpb + (size_t)l * NH * 15 * 31, lat ? (u >> 8) : (v >> 4), lat ? ((u >> 4) & 15) : (v & 15), lat ? (u & 15) : -1);
            }
        }
        SEAM(pb + 3);
        if ((PH_MASK & 32) && IN(pb + 4)) {
            OrderSq S; S.A = F.YZ; S.W = F.WBR + (size_t)l * DM * DM; S.nM = nMfull; S.G = F.G; S.c = (int)blockIdx.x;
            EpiMerge E; E.MRG = F.MRG; E.P = F.P;
            pg8::gemm_phase<EpiMerge, OrderSq>(F.lds, DM, DM, DM, S, E);
        }
        SEAM(pb + 4);
        if ((PH_MASK & 64) && IN(pb + 5)) {
            OrderSq S; S.A = F.MRG; S.W = F.WOUT + (size_t)l * DM * DM; S.nM = nMfull; S.G = F.G; S.c = (int)blockIdx.x;
            EpiOut E; E.xold_lat = l == 0 ? F.x : F.XL; E.xold_ctx = F.ctx; E.xnew_lat = lastl ? F.out : F.XL; E.xnew_ctx = F.XC; E.gt = F.GT + (size_t)l * 3 * DM;
            pg8::gemm_phase<EpiOut, OrderSq>(F.lds, DM, DM, DM, S, E);
        }
        SEAM(pb + 5);
    }
    if ((PH_MASK & 128) && IN(N_PHASES - 1)) { p_final(F); }
#undef IN
#undef SEAM
}

extern "C" void kernel_launch(void* const* d_in, const int* in_sizes, int n_in, void* d_out, int out_size, void* d_ws, size_t ws_size, hipStream_t stream) {
    static int grid = 0;
    if (grid == 0) {
        if (n_in != 16 || out_size != MLAT * DM || ws_size < WS_END) { fprintf(stderr, "kernel_launch: unexpected shapes (n_in %d out %d ws %zu, need ws >= %zu)\n", n_in, out_size, ws_size, (size_t)WS_END); grid = -1; return; }
        int dev = 0, cus = 0, per_cu = 0;
        if (hipGetDevice(&dev) != hipSuccess || hipDeviceGetAttribute(&cus, hipDeviceAttributeMultiprocessorCount, dev) != hipSuccess) { grid = -1; return; }
        if (hipFuncSetAttribute((const void*)mk_fwd, hipFuncAttributeMaxDynamicSharedMemorySize, LDS_BYTES) != hipSuccess) { fprintf(stderr, "kernel_launch: hipFuncSetAttribute failed\n"); grid = -1; return; }
        if (hipOccupancyMaxActiveBlocksPerMultiprocessor(&per_cu, (const void*)mk_fwd, NWAVES * 64, LDS_BYTES) != hipSuccess || per_cu < 1)
            fprintf(stderr, "kernel_launch: note: occupancy query reports %d workgroups per CU\n", per_cu);
        (void)hipGetLastError();
        grid = cus;
    }
    if (grid < 0) return;
    if (hipMemsetAsync((char*)d_ws + WS_CTL, 0, CTL_ZERO_BYTES, stream) != hipSuccess) return;
    Args a{};
    for (int i = 0; i < 16; ++i) a.in[i] = (const float*)d_in[i];
    a.out = (float*)d_out; a.ws = (unsigned char*)d_ws;
    if (MK_N_LAUNCHES == 1) { a.ph_lo = 0; a.ph_hi = N_PHASES; hipLaunchKernelGGL(mk_fwd, dim3(grid), dim3(NWAVES * 64), LDS_BYTES, stream, a); }
    else for (int p = 0; p < N_PHASES; ++p) { a.ph_lo = p; a.ph_hi = p + 1; hipLaunchKernelGGL(mk_fwd, dim3(grid), dim3(NWAVES * 64), LDS_BYTES, stream, a); }
    const hipError_t le = hipPeekAtLastError();
    if (le != hipSuccess) fprintf(stderr, "kernel_launch: launch failed: %s\n", hipGetErrorName(le));
}
```
